# Optimizing an MI355X kernel written in HIP

```python
import math
import jax, jax.numpy as jnp
from jax import lax
import numpy as np

D_MODEL = 2048
BATCH = 2
SEQ = 8192
DEPTH = 1

RET_HEADS = 8
RET_DK = 128
RET_DV = 128
RET_CHUNK = 128
ROPE_BASE = 10000.0
SWA_HEADS = 16
SWA_KV_HEADS = 4
SWA_HD = 64
SWA_WINDOW = 128
SWA_BLOCK = 128
REL_BUCKETS = 32
REL_MAX_DIST = 128
MEM_LEN = 256
XA_HEADS = 4
XA_HD = D_MODEL // XA_HEADS
D_FF = 5632
CONV_W = 3
LN_EPS = 1e-5
DN_ALPHA = (2 * DEPTH) ** 0.25
DN_BETA = (8 * DEPTH) ** -0.25

RET_W = RET_HEADS * RET_DV
SWA_W = SWA_HEADS * SWA_HD
MIX_W = RET_W + SWA_W
SWA_KV_W = SWA_KV_HEADS * SWA_HD
SPLIT_SIZES = (RET_HEADS * RET_DK, RET_HEADS * RET_DK, RET_W, RET_W, SWA_W, SWA_KV_W, SWA_KV_W)
IN_W = sum(SPLIT_SIZES)

kernel_name = "hybrid_retention_swa_sink_deepnorm_layer"


def layer_norm(x, g, b):
    xf = x.astype(jnp.float32)
    mu = jnp.mean(xf, axis=-1, keepdims=True)
    var = jnp.mean(jnp.square(xf - mu), axis=-1, keepdims=True)
    y = (xf - mu) * lax.rsqrt(var + LN_EPS)
    return (y * g.astype(jnp.float32) + b.astype(jnp.float32)).astype(x.dtype)


def rotate(x, pos):
    half = x.shape[-1] // 2
    inv = 1.0 / (ROPE_BASE ** (jnp.arange(half, dtype=jnp.float32) / half))
    ang = pos.astype(jnp.float32)[:, None] * inv[None, :]
    cos = jnp.cos(ang)[None, :, None, :]
    sin = jnp.sin(ang)[None, :, None, :]
    x1, x2 = x[..., :half], x[..., half:]
    return jnp.concatenate([x1 * cos - x2 * sin, x1 * sin + x2 * cos], axis=-1)


def retention(q, k, v):
    B, S, H, dk = q.shape
    dv = v.shape[-1]
    C = RET_CHUNK
    NC = S // C
    log_gamma = jnp.log1p(-jnp.exp2(-5.0 - jnp.arange(H, dtype=jnp.float32)))
    idx = jnp.arange(C, dtype=jnp.float32)
    diff = idx[:, None] - idx[None, :]
    dmat = jnp.where(diff[None] >= 0,
                     jnp.exp(log_gamma[:, None, None] * jnp.maximum(diff, 0.0)[None]),
                     0.0)
    qc = q.reshape(B, NC, C, H, dk)
    kc = k.reshape(B, NC, C, H, dk)
    vc = v.reshape(B, NC, C, H, dv)
    scores = jnp.einsum('bnihd,bnjhd->bnhij', qc, kc) * dmat
    o_intra = jnp.einsum('bnhij,bnjhe->bnihe', scores, vc)
    k_decay = jnp.exp(log_gamma[:, None] * (C - 1 - idx)[None, :])
    kv = jnp.einsum('bnjhd,hj,bnjhe->bnhde', kc, k_decay, vc)
    chunk_decay = jnp.exp(log_gamma * C)[:, None, None]

    def step(state, kv_n):
        return state * chunk_decay + kv_n, state

    _, prev = lax.scan(step, jnp.zeros((B, H, dk, dv), jnp.float32), jnp.moveaxis(kv, 1, 0))
    prev = jnp.moveaxis(prev, 0, 1)
    q_decay = jnp.exp(log_gamma[:, None] * (idx + 1.0)[None, :])
    o_cross = jnp.einsum('bnihd,bnhde->bnihe', qc, prev) * q_decay.T[None, None, :, :, None]
    return (o_intra + o_cross).reshape(B, S, H, dv)


def t5_bucket(n):
    max_exact = REL_BUCKETS // 2
    nf = jnp.maximum(n, 1).astype(jnp.float32)
    large = max_exact + (jnp.log(nf / max_exact) / math.log(REL_MAX_DIST / max_exact)
                         * (REL_BUCKETS - max_exact)).astype(jnp.int32)
    large = jnp.minimum(large, REL_BUCKETS - 1)
    return jnp.where(n < max_exact, n, large)


def swa_sink_attention(q, k, v, sinks, rel_bias):
    B, S, Hq, d = q.shape
    Hkv = k.shape[2]
    G = Hq // Hkv
    L = SWA_BLOCK
    NB = S // L
    qb = q.reshape(B, NB, L, Hkv, G, d)

    def band(t):
        tb = t.reshape(B, NB, L, Hkv, d)
        prev = jnp.pad(tb, ((0, 0), (1, 0), (0, 0), (0, 0), (0, 0)))[:, :NB]
        return jnp.concatenate([prev, tb], axis=2)

    kb, vb = band(k), band(v)
    logits = jnp.einsum('bnikgd,bnjkd->bnkgij', qb, kb).astype(jnp.float32) * (d ** -0.5)
    i = jnp.arange(L)[:, None]
    j = jnp.arange(2 * L)[None, :]
    dist = i + L - j
    blk = jnp.arange(NB)[:, None, None]
    valid = (dist >= 0) & (dist < SWA_WINDOW) & (blk * L + j - L >= 0)
    bias = rel_bias.astype(jnp.float32)[t5_bucket(jnp.maximum(dist, 0))]
    bias = jnp.transpose(bias, (2, 0, 1)).reshape(Hkv, G, L, 2 * L)
    logits = jnp.where(valid[None, :, None, None], logits + bias[None, None], -jnp.inf)
    sink = sinks.astype(jnp.float32).reshape(Hkv, G)[None, None, :, :, None, None]
    m = jnp.maximum(jnp.max(logits, axis=-1, keepdims=True), sink)
    p = jnp.exp(logits - m)
    p = p / (jnp.sum(p, axis=-1, keepdims=True) + jnp.exp(sink - m))
    out = jnp.einsum('bnkgij,bnjkd->bnikgd', p.astype(vb.dtype), vb)
    return out.reshape(B, S, Hq * d)


def memory_cross_attention(x, mem, wq, wkv, wo):
    B, S, _ = x.shape
    q = (x @ wq).reshape(B, S, XA_HEADS, XA_HD)
    kv = mem @ wkv
    k, v = jnp.split(kv, 2, axis=-1)
    k = k.reshape(B, -1, XA_HEADS, XA_HD)
    v = v.reshape(B, -1, XA_HEADS, XA_HD)
    logits = jnp.einsum('bshd,bmhd->bhsm', q, k).astype(jnp.float32) * (XA_HD ** -0.5)
    p = jax.nn.softmax(logits, axis=-1).astype(v.dtype)
    o = jnp.einsum('bhsm,bmhd->bshd', p, v).reshape(B, S, D_MODEL)
    return o @ wo


def conv_ffn(x, w_up, conv_w, conv_b, w_down):
    S = x.shape[1]
    u, g = jnp.split(x @ w_up, 2, axis=-1)
    gp = jnp.pad(g, ((0, 0), (CONV_W - 1, 0), (0, 0)))
    gc = conv_b + sum(gp[:, tap:tap + S] * conv_w[tap] for tap in range(CONV_W))
    return (jax.nn.silu(gc) * u) @ w_down


def setup_inputs(seed: int = 0) -> dict:
    key = jax.random.key(seed)
    ks = jax.random.split(key, 24)
    f32 = jnp.float32

    def nrm(k, shape, scale):
        return jax.random.normal(k, shape, f32) * scale

    col_scale = jnp.concatenate([
        jnp.full((SPLIT_SIZES[0],), 1.0, f32), jnp.full((SPLIT_SIZES[1],), 1.0, f32),
        jnp.full((SPLIT_SIZES[2],), DN_BETA, f32), jnp.full((SPLIT_SIZES[3],), 1.0, f32),
        jnp.full((SPLIT_SIZES[4],), 1.0, f32), jnp.full((SPLIT_SIZES[5],), 1.0, f32),
        jnp.full((SPLIT_SIZES[6],), DN_BETA, f32)])
    xa_kv_scale = jnp.concatenate([jnp.ones((D_MODEL,), f32), jnp.full((D_MODEL,), DN_BETA, f32)])
    return {
        "x": nrm(ks[0], (BATCH, SEQ, D_MODEL), 1.0),
        "mem": nrm(ks[1], (BATCH, MEM_LEN, D_MODEL), 1.0),
        "w_in": nrm(ks[2], (DEPTH, D_MODEL, IN_W), D_MODEL ** -0.5) * col_scale,
        "ret_gn_g": 1.0 + nrm(ks[3], (DEPTH, RET_W), 0.01),
        "swa_sinks": nrm(ks[4], (DEPTH, SWA_HEADS), 0.5),
        "rel_bias": nrm(ks[5], (REL_BUCKETS, SWA_HEADS), 0.5),
        "w_o": nrm(ks[6], (DEPTH, MIX_W, D_MODEL), MIX_W ** -0.5 * DN_BETA),
        "ln1_g": 1.0 + nrm(ks[7], (DEPTH, D_MODEL), 0.01),
        "ln1_b": nrm(ks[8], (DEPTH, D_MODEL), 0.01),
        "xa_wq": nrm(ks[9], (DEPTH, D_MODEL, D_MODEL), D_MODEL ** -0.5),
        "xa_wkv": nrm(ks[10], (DEPTH, D_MODEL, 2 * D_MODEL), D_MODEL ** -0.5) * xa_kv_scale,
        "xa_wo": nrm(ks[11], (DEPTH, D_MODEL, D_MODEL), D_MODEL ** -0.5 * DN_BETA),
        "ln2_g": 1.0 + nrm(ks[12], (DEPTH, D_MODEL), 0.01),
        "ln2_b": nrm(ks[13], (DEPTH, D_MODEL), 0.01),
        "ffn_w_up": nrm(ks[14], (DEPTH, D_MODEL, 2 * D_FF), D_MODEL ** -0.5 * DN_BETA),
        "ffn_conv_w": nrm(ks[15], (DEPTH, CONV_W, D_FF), CONV_W ** -0.5),
        "ffn_conv_b": nrm(ks[16], (DEPTH, D_FF), 0.01),
        "ffn_w_down": nrm(ks[17], (DEPTH, D_FF, D_MODEL), D_FF ** -0.5 * DN_BETA),
        "ln3_g": 1.0 + nrm(ks[18], (DEPTH, D_MODEL), 0.01),
        "ln3_b": nrm(ks[19], (DEPTH, D_MODEL), 0.01),
    }


def reference(x, mem, w_in, ret_gn_g, swa_sinks, rel_bias, w_o, ln1_g, ln1_b,
              xa_wq, xa_wkv, xa_wo, ln2_g, ln2_b,
              ffn_w_up, ffn_conv_w, ffn_conv_b, ffn_w_down, ln3_g, ln3_b):
    B, S, _ = x.shape
    pos = jnp.arange(S)
    offsets = [int(o) for o in np.cumsum(SPLIT_SIZES)[:-1]]
    for l in range(DEPTH):
        proj = x @ w_in[l]
        q_r, k_r, v_r, g_r, q_s, k_s, v_s = jnp.split(proj, offsets, axis=-1)
        qr = rotate(q_r.astype(jnp.float32).reshape(B, S, RET_HEADS, RET_DK), pos)
        kr = rotate(k_r.astype(jnp.float32).reshape(B, S, RET_HEADS, RET_DK), pos) * (RET_DK ** -0.5)
        vr = v_r.astype(jnp.float32).reshape(B, S, RET_HEADS, RET_DV)
        o_r = retention(qr, kr, vr)
        mu = jnp.mean(o_r, axis=-1, keepdims=True)
        var = jnp.mean(jnp.square(o_r - mu), axis=-1, keepdims=True)
        o_r = ((o_r - mu) * lax.rsqrt(var + LN_EPS)).reshape(B, S, RET_W) * ret_gn_g[l].astype(jnp.float32)
        o_r = (jax.nn.silu(g_r.astype(jnp.float32)) * o_r).astype(x.dtype)
        o_s = swa_sink_attention(q_s.reshape(B, S, SWA_HEADS, SWA_HD),
                                 k_s.reshape(B, S, SWA_KV_HEADS, SWA_HD),
                                 v_s.reshape(B, S, SWA_KV_HEADS, SWA_HD),
                                 swa_sinks[l], rel_bias).astype(x.dtype)
        mix = jnp.concatenate([o_r, o_s], axis=-1) @ w_o[l]
        x = layer_norm(DN_ALPHA * x + mix, ln1_g[l], ln1_b[l])
        xa = memory_cross_attention(x, mem, xa_wq[l], xa_wkv[l], xa_wo[l])
        x = layer_norm(DN_ALPHA * x + xa, ln2_g[l], ln2_b[l])
        ff = conv_ffn(x, ffn_w_up[l], ffn_conv_w[l], ffn_conv_b[l], ffn_w_down[l])
        x = layer_norm(DN_ALPHA * x + ff, ln3_g[l], ln3_b[l])
    return x
```

```cpp
#include <hip/hip_runtime.h>
#include <cstdio>
#include <cstdint>

#ifndef MK_ONE_LAUNCH
#define MK_ONE_LAUNCH 0
#endif

#define LAS __attribute__((address_space(3)))
#define GAS __attribute__((address_space(1)))
typedef unsigned short bf16_t;
typedef short bf16x8 __attribute__((ext_vector_type(8)));
typedef float f32x4 __attribute__((ext_vector_type(4)));
typedef float f32x2 __attribute__((ext_vector_type(2)));
typedef unsigned u32x4 __attribute__((ext_vector_type(4)));
typedef unsigned u32x2 __attribute__((ext_vector_type(2)));

constexpr int BATCH = 2, SEQ = 8192, DM = 2048, MTOK = BATCH * SEQ;
constexpr int INW = 5632, DFF = 5632, MEML = 256;
constexpr int OFF_QR = 0, OFF_KR = 1024, OFF_VR = 2048, OFF_GR = 3072, OFF_QS = 4096, OFF_KS = 5120, OFF_VS = 5376;
constexpr float LN_EPS = 1e-5f;
constexpr float DN_ALPHA = 1.189207115002721f;
constexpr float LOG2E = 1.4426950408889634f;
constexpr int NWAVES = 8, NTHR = 512;

constexpr size_t MiB = 1u << 20;
constexpr size_t WS_CTL = 0, CTL_ZERO_BYTES = 1 * MiB;
constexpr size_t WS_ROPE = 1 * MiB;
constexpr size_t WS_MEMB = 5 * MiB, WS_KX = 7 * MiB, WS_VXT = 9 * MiB, WS_BIAS = 11 * MiB;
constexpr size_t WS_WIN = 24 * MiB, WS_WO = 46 * MiB, WS_WQ = 54 * MiB, WS_WKV = 62 * MiB, WS_WXO = 78 * MiB, WS_WUP = 86 * MiB, WS_WDN = 130 * MiB;
constexpr size_t WS_XB = 152 * MiB;
constexpr size_t WS_KVST = 152 * MiB, WS_QX = 152 * MiB, WS_TG = 152 * MiB, WS_TU = 164 * MiB, WS_HG = 176 * MiB;
constexpr size_t WS_PROJ = 216 * MiB;
constexpr size_t WS_PBUF = 216 * MiB, WS_OX = 248 * MiB, WS_ACT = 216 * MiB;
constexpr size_t WS_MIX = 392 * MiB, WS_XNB = 392 * MiB;
constexpr size_t WS_PREV = 456 * MiB;
constexpr size_t WS_END = 488 * MiB;
constexpr int CW_BAR = 4096;

constexpr int LDS_BYTES = 147456;
constexpr int MISC_OFF = LDS_BYTES - 256;

#define RLX_AGENT __ATOMIC_RELAXED, __HIP_MEMORY_SCOPE_AGENT
#define LDS_WAIT() asm volatile("s_waitcnt lgkmcnt(0)" ::: "memory")
#define VM_WAIT() asm volatile("s_waitcnt vmcnt(0)" ::: "memory")
#define WG_BARRIER() do { asm volatile("s_waitcnt vmcnt(0) lgkmcnt(0)" ::: "memory"); __builtin_amdgcn_s_barrier(); asm volatile("" ::: "memory"); } while (0)

__device__ __forceinline__ unsigned cvt_pk_bf16(float lo, float hi) { unsigned r; asm volatile("v_cvt_pk_bf16_f32 %0, %1, %2" : "=v"(r) : "v"(lo), "v"(hi)); return r; }
__device__ __forceinline__ float bf_lo(unsigned w) { return __uint_as_float(w << 16); }
__device__ __forceinline__ float bf_hi(unsigned w) { return __uint_as_float(w & 0xffff0000u); }
__device__ __forceinline__ float fast_exp2(float x) { return __builtin_amdgcn_exp2f(x); }
__device__ __forceinline__ float fast_rcp(float x) { return __builtin_amdgcn_rcpf(x); }
__device__ __forceinline__ float silu_f(float x) { return x * fast_rcp(1.0f + fast_exp2(-x * LOG2E)); }
#define MFMA16(x, y, c) __builtin_amdgcn_mfma_f32_16x16x32_bf16((x), (y), (c), 0, 0, 0)

namespace pg8 {
constexpr int BM = 256, BK = 64, HALF = 128, HTB = HALF * BK * 2, STAGE_BYTES = 8 * HTB, NXCD = 8, WGM = 8;
__host__ __device__ __forceinline__ int lds_byte(int r, int c) { const int st = (r >> 4) * 2 + (c >> 5), rr = r & 15, cc = c & 31, ob = rr * 64 + cc * 2; return st * 1024 + (ob ^ (((ob >> 9) & 1) << 5)); }
__host__ __device__ __forceinline__ void stage_rc(int b, int& R, int& C) { const int st = b / 1024, sb = b % 1024, swz = sb ^ (((sb >> 9) & 1) << 5); R = (st >> 1) * 16 + swz / 64; C = (st & 1) * 32 + (swz % 64) / 2; }
__host__ __device__ __forceinline__ int perm32(int rho) { const int n = rho >> 4, i = rho & 15; return 8 * (i >> 2) + 4 * n + (i & 3); }

struct Unit { int pm, pn, z1, z2; };
struct Gemm { const bf16_t* A; const bf16_t* Bt; int lda, ldb, K; long sA1, sA2, sB1, sB2; };

struct StaticOrder {
    int nM, nN, nwg, G, c;
    __device__ void init(int M, int N, int G_, int c_) { nM = M / BM; nN = N / BM; nwg = nM * nN; G = G_; c = c_; }
    __device__ bool next(int i, Unit& u) const {
        if (c < 0) return false;
        const long L = (long)i * G + c; if (L >= nwg) return false;
        int wgid = (int)L; { const int q = nwg / NXCD, r = nwg % NXCD, xcd = wgid % NXCD, off = wgid / NXCD; wgid = (xcd < r ? xcd * (q + 1) : r * (q + 1) + (xcd - r) * q) + off; }
        const int nig = WGM * nN, gid = wgid / nig, fm = gid * WGM, gsz = (nM - fm) < WGM ? (nM - fm) : WGM;
        u.pm = fm + ((wgid % nig) % gsz); u.pn = (wgid % nig) / gsz; u.z1 = 0; u.z2 = 0; return true;
    }
};
struct OrderQK {
    int G, c;
    __device__ bool next(int i, Unit& u) const { const int L = i * G + c; if (L >= 256) return false; u.z1 = L >> 7; u.z2 = (L >> 5) & 3; u.pm = L & 31; u.pn = 0; return true; }
};
struct OrderPV {
    int G, c;
    __device__ bool next(int i, Unit& u) const { const int L = i * G + c; if (L >= 512) return false; u.z1 = L >> 8; u.z2 = (L >> 6) & 3; u.pm = (L >> 1) & 31; u.pn = L & 1; return true; }
};

typedef f32x4 Acc[2][2][4][2];

struct EpiBf16G {
    static constexpr bool PERM = true, AFTER_DRAIN = false;
    bf16_t* O; int ldc; float scale; long sO1, sO2;
    __device__ __forceinline__ void operator()(const Acc& acc, const Unit& u, int wr, int wc, int fr, int fq) const {
        bf16_t* base = O + u.z1 * sO1 + u.z2 * sO2;
        const int row0 = u.pm * BM + wr * 64 + fr, col0 = u.pn * BM + wc * 32 + 8 * fq;
#pragma unroll
        for (int ai = 0; ai < 2; ++ai)
#pragma unroll
            for (int m = 0; m < 4; ++m) { bf16_t* rowp = base + (size_t)(row0 + ai * HALF + m * 16) * ldc + col0;
#pragma unroll
                for (int bj = 0; bj < 2; ++bj) { const f32x4 v0 = acc[ai][bj][m][0] * scale, v1 = acc[ai][bj][m][1] * scale;
                    u32x4 w; w.x = cvt_pk_bf16(v0[0], v0[1]); w.y = cvt_pk_bf16(v0[2], v0[3]); w.z = cvt_pk_bf16(v1[0], v1[1]); w.w = cvt_pk_bf16(v1[2], v1[3]);
                    *(u32x4*)(rowp + bj * HALF) = w; } }
    }
};
struct EpiProj {
    static constexpr bool PERM = true, AFTER_DRAIN = false;
    bf16_t* O; const float* cosT; const float* sinT;
    __device__ __forceinline__ void operator()(const Acc& acc, const Unit& u, int wr, int wc, int fr, int fq) const {
        const int row0 = u.pm * BM + wr * 64 + fr, col0 = u.pn * BM + wc * 32 + 8 * fq;
        if (u.pn < 8) {
            const float sc = (u.pn >= 4) ? 0.08838834764831845f : 1.0f;
            const int i0 = 16 * wc + 4 * fq;
#pragma unroll
            for (int ai = 0; ai < 2; ++ai)
#pragma unroll
                for (int m = 0; m < 4; ++m) { const int row = row0 + ai * HALF + m * 16; const int pos = row & (SEQ - 1);
                    const f32x4 cs = *(const f32x4*)(cosT + pos * 64 + i0), sn = *(const f32x4*)(sinT + pos * 64 + i0);
                    bf16_t* rowp = O + (size_t)row * INW + col0;
#pragma unroll
                    for (int bj = 0; bj < 2; ++bj) { const f32x4 x1 = acc[ai][bj][m][0], x2 = acc[ai][bj][m][1];
                        const f32x4 v0 = (x1 * cs - x2 * sn) * sc, v1 = (x1 * sn + x2 * cs) * sc;
                        u32x4 w; w.x = cvt_pk_bf16(v0[0], v0[1]); w.y = cvt_pk_bf16(v0[2], v0[3]); w.z = cvt_pk_bf16(v1[0], v1[1]); w.w = cvt_pk_bf16(v1[2], v1[3]);
                        *(u32x4*)(rowp + bj * HALF) = w; } }
        } else {
            const float sc = (u.pn >= 16 && u.pn < 20) ? 0.125f : 1.0f;
#pragma unroll
            for (int ai = 0; ai < 2; ++ai)
#pragma unroll
                for (int m = 0; m < 4; ++m) { bf16_t* rowp = O + (size_t)(row0 + ai * HALF + m * 16) * INW + col0;
#pragma unroll
                    for (int bj = 0; bj < 2; ++bj) { const f32x4 v0 = acc[ai][bj][m][0] * sc, v1 = acc[ai][bj][m][1] * sc;
                        u32x4 w; w.x = cvt_pk_bf16(v0[0], v0[1]); w.y = cvt_pk_bf16(v0[2], v0[3]); w.z = cvt_pk_bf16(v1[0], v1[1]); w.w = cvt_pk_bf16(v1[2], v1[3]);
                        *(u32x4*)(rowp + bj * HALF) = w; } }
        }
    }
};
struct EpiResF32 {
    static constexpr bool PERM = false, AFTER_DRAIN = false;
    const float* res; float* out; float alpha;
    __device__ __forceinline__ void operator()(const Acc& acc, const Unit& u, int wr, int wc, int fr, int fq) const {
        const int row0 = u.pm * BM + wr * 64 + fr, col0 = u.pn * BM + wc * 32 + 4 * fq;
#pragma unroll
        for (int ai = 0; ai < 2; ++ai)
#pragma unroll
            for (int m = 0; m < 4; ++m) { const size_t off = (size_t)(row0 + ai * HALF + m * 16) * DM + col0;
                f32x4 rv[2][2];
#pragma unroll
                for (int bj = 0; bj < 2; ++bj)
#pragma unroll
                    for (int n = 0; n < 2; ++n) rv[bj][n] = *(const f32x4*)(res + off + bj * HALF + n * 16);
#pragma unroll
                for (int bj = 0; bj < 2; ++bj)
#pragma unroll
                    for (int n = 0; n < 2; ++n) *(f32x4*)(out + off + bj * HALF + n * 16) = acc[ai][bj][m][n] + rv[bj][n] * alpha; }
    }
};
struct EpiSoftmax {
    static constexpr bool PERM = true, AFTER_DRAIN = true;
    bf16_t* P;
    __device__ __forceinline__ void fused(Acc& acc, const Unit& u, int wr, int wc, int fr, int fq, LAS unsigned char* lds, int wid, int lane) const {
        LAS float* RM = (LAS float*)lds;
        LAS float* RS = (LAS float*)(lds + 4096);
        float mx[2][4];
#pragma unroll
        for (int ai = 0; ai < 2; ++ai)
#pragma unroll
            for (int m = 0; m < 4; ++m) { float a = -INFINITY;
#pragma unroll
                for (int bj = 0; bj < 2; ++bj)
#pragma unroll
                    for (int n = 0; n < 2; ++n) { const f32x4 x = acc[ai][bj][m][n]; a = fmaxf(a, fmaxf(fmaxf(x[0], x[1]), fmaxf(x[2], x[3]))); }
                a = fmaxf(a, __shfl_xor(a, 16)); a = fmaxf(a, __shfl_xor(a, 32));
                if (fq == 0) RM[(ai * HALF + wr * 64 + m * 16 + fr) * 4 + wc] = a; }
        asm volatile("s_waitcnt lgkmcnt(0)" ::: "memory"); __builtin_amdgcn_s_barrier(); asm volatile("" ::: "memory");
#pragma unroll
        for (int ai = 0; ai < 2; ++ai)
#pragma unroll
            for (int m = 0; m < 4; ++m) { const int r = ai * HALF + wr * 64 + m * 16 + fr; const f32x4 q = *(const LAS f32x4*)(RM + r * 4);
                const float mm = fmaxf(fmaxf(q[0], q[1]), fmaxf(q[2], q[3])); float s = 0.f;
#pragma unroll
                for (int bj = 0; bj < 2; ++bj)
#pragma unroll
                    for (int n = 0; n < 2; ++n) { f32x4 x = acc[ai][bj][m][n]; x[0] = fast_exp2(x[0] - mm); x[1] = fast_exp2(x[1] - mm); x[2] = fast_exp2(x[2] - mm); x[3] = fast_exp2(x[3] - mm);
                        s += (x[0] + x[1]) + (x[2] + x[3]); acc[ai][bj][m][n] = x; }
                s += __shfl_xor(s, 16); s += __shfl_xor(s, 32);
                if (fq == 0) RS[r * 4 + wc] = s; }
        asm volatile("s_waitcnt lgkmcnt(0)" ::: "memory"); __builtin_amdgcn_s_barrier(); asm volatile("" ::: "memory");
        bf16_t* base = P + (size_t)u.z2 * ((size_t)MTOK * 256) + ((size_t)u.z1 * SEQ + u.pm * BM) * 256;
#pragma unroll
        for (int ai = 0; ai < 2; ++ai)
#pragma unroll
            for (int m = 0; m < 4; ++m) { const int r = ai * HALF + wr * 64 + m * 16 + fr; const f32x4 q = *(const LAS f32x4*)(RS + r * 4);
                const float inv = 1.0f / ((q[0] + q[1]) + (q[2] + q[3]));
                bf16_t* rowp = base + (size_t)r * 256 + wc * 32 + 8 * fq;
#pragma unroll
                for (int bj = 0; bj < 2; ++bj) { const f32x4 v0 = acc[ai][bj][m][0] * inv, v1 = acc[ai][bj][m][1] * inv;
                    u32x4 w; w.x = cvt_pk_bf16(v0[0], v0[1]); w.y = cvt_pk_bf16(v0[2], v0[3]); w.z = cvt_pk_bf16(v1[0], v1[1]); w.w = cvt_pk_bf16(v1[2], v1[3]);
                    *(u32x4*)(rowp + bj * HALF) = w; } }
    }
};
struct EpiUpGate {
    static constexpr bool PERM = true, AFTER_DRAIN = false;
    bf16_t* act; float* TG; float* TU; float* HG; const float* cw; const float* cb;
    __device__ __forceinline__ void operator()(const Acc& acc, const Unit& u, int wr, int wc, int fr, int fq) const {
        const int f0 = u.pn * 128 + wc * 32 + 8 * fq;
        f32x4 w0[2], w1[2], w2[2], bb[2];
#pragma unroll
        for (int n = 0; n < 2; ++n) { w0[n] = *(const f32x4*)(cw + f0 + 4 * n); w1[n] = *(const f32x4*)(cw + DFF + f0 + 4 * n); w2[n] = *(const f32x4*)(cw + 2 * DFF + f0 + 4 * n); bb[n] = *(const f32x4*)(cb + f0 + 4 * n); }
        const int lane = fq * 16 + fr, src1 = (lane & 48) | ((fr + 15) & 15), src2 = (lane & 48) | ((fr + 14) & 15);
#pragma unroll
        for (int ai = 0; ai < 2; ++ai) {
            const int G = u.pm * 4 + ai * 2 + wr;
            f32x4 p1[2], p2[2];
#pragma unroll
            for (int n = 0; n < 2; ++n) { p1[n] = (f32x4){0.f, 0.f, 0.f, 0.f}; p2[n] = p1[n]; }
#pragma unroll
            for (int m = 0; m < 4; ++m) {
                f32x4 r1[2], r2[2], a[2];
#pragma unroll
                for (int n = 0; n < 2; ++n) { const f32x4 g = acc[ai][1][m][n], uu = acc[ai][0][m][n];
#pragma unroll
                    for (int j = 0; j < 4; ++j) { r1[n][j] = __shfl(g[j], src1); r2[n][j] = __shfl(g[j], src2); }
                    f32x4 g1, g2;
#pragma unroll
                    for (int j = 0; j < 4; ++j) { g1[j] = (fr >= 1) ? r1[n][j] : p1[n][j]; g2[j] = (fr >= 2) ? r2[n][j] : p2[n][j]; }
                    const f32x4 gc = bb[n] + w0[n] * g2 + w1[n] * g1 + w2[n] * g;
#pragma unroll
                    for (int j = 0; j < 4; ++j) a[n][j] = silu_f(gc[j]) * uu[j];
                }
                const int row = u.pm * BM + ai * HALF + wr * 64 + m * 16 + fr;
                if (m == 0 && fr < 2) {
                    const size_t o = (size_t)(G * 2 + fr) * DFF + f0;
                    *(f32x4*)(TG + o) = acc[ai][1][m][0]; *(f32x4*)(TG + o + 4) = acc[ai][1][m][1];
                    *(f32x4*)(TU + o) = acc[ai][0][m][0]; *(f32x4*)(TU + o + 4) = acc[ai][0][m][1];
                } else {
                    u32x4 w; w.x = cvt_pk_bf16(a[0][0], a[0][1]); w.y = cvt_pk_bf16(a[0][2], a[0][3]); w.z = cvt_pk_bf16(a[1][0], a[1][1]); w.w = cvt_pk_bf16(a[1][2], a[1][3]);
                    *(u32x4*)(act + (size_t)row * DFF + f0) = w;
                }
                if (m == 3 && fr >= 14) { const size_t o = (size_t)(G * 2 + fr - 14) * DFF + f0; *(f32x4*)(HG + o) = acc[ai][1][m][0]; *(f32x4*)(HG + o + 4) = acc[ai][1][m][1]; }
#pragma unroll
                for (int n = 0; n < 2; ++n) { p1[n] = r1[n]; p2[n] = r2[n]; }
            }
        }
    }
};

template <class Epi, class Sched, bool ALIGN_EPI>
__device__ __forceinline__ void gemm_phase(LAS unsigned char* lds, const Gemm g, const Sched& S, const Epi& E) {
    const int tid = threadIdx.x, wid = __builtin_amdgcn_readfirstlane(tid >> 6), lane = tid & 63, wr = wid >> 2, wc = wid & 3, fr = lane & 15, fq = lane >> 4;
    const int K = g.K, nt = K / BK;
    unsigned voffA[2], voffB[2];
#pragma unroll
    for (int i = 0; i < 2; ++i) { int R, C; stage_rc(tid * 16 + i * 8192, R, C); const int Rb = Epi::PERM ? ((R & ~31) + perm32(R & 31)) : R;
        voffA[i] = (unsigned)(R * g.lda + C) * 2u; voffB[i] = (unsigned)(Rb * g.ldb + C) * 2u; }
    const size_t kstep = (size_t)(BK * 2);
    const size_t hstepA = (size_t)HALF * g.lda * 2, hstepB = (size_t)HALF * g.ldb * 2;
    const unsigned ldsw = (unsigned)wid * 1024u;
    const int aoff = lds_byte(wr * 64 + fr, fq * 8), boff = lds_byte(wc * 32 + fr, fq * 8);
#define PG8_SA(b, h) (((b) * 2 + (h)) * HTB)
#define PG8_SB(b, h) ((4 + (b) * 2 + (h)) * HTB)
#define PG8_STAGE(bufoff, gbase, voff) do { _Pragma("unroll") for (int _i = 0; _i < 2; ++_i) \
        __builtin_amdgcn_global_load_lds((const unsigned*)((const char*)(gbase) + (voff)[_i]), (LAS unsigned*)(lds + (bufoff) + ldsw + _i * 8192), 16, 0, 0); } while (0)
#define PG8_LDA(dst, b, h) do { _Pragma("unroll") for (int m = 0; m < 4; ++m) _Pragma("unroll") for (int k = 0; k < 2; ++k) dst[m][k] = *(const LAS bf16x8*)(lds + PG8_SA(b, h) + aoff + m * 2048 + k * 1024); } while (0)
#define PG8_LDB(dst, b, h) do { _Pragma("unroll") for (int n = 0; n < 2; ++n) _Pragma("unroll") for (int k = 0; k < 2; ++k) dst[n][k] = *(const LAS bf16x8*)(lds + PG8_SB(b, h) + boff + n * 2048 + k * 1024); } while (0)
#define PG8_MMA(ai, bj, At, Bt) do { __builtin_amdgcn_s_setprio(1); _Pragma("unroll") for (int m = 0; m < 4; ++m) _Pragma("unroll") for (int n = 0; n < 2; ++n) _Pragma("unroll") for (int k = 0; k < 2; ++k) \
        acc[ai][bj][m][n] = __builtin_amdgcn_mfma_f32_16x16x32_bf16(Bt[n][k], At[m][k], acc[ai][bj][m][n], 0, 0, 0); __builtin_amdgcn_s_setprio(0); } while (0)
#define PG8_WAIT_V(n) asm volatile("s_waitcnt vmcnt(" #n ")" ::: "memory")
#define PG8_WAIT_L(n) asm volatile("s_waitcnt lgkmcnt(" #n ")" ::: "memory")
#define PG8_BAR __builtin_amdgcn_s_barrier()
#define PG8_SCHED __builtin_amdgcn_sched_barrier(0)
    Unit cur, nxt; int ui = 0;
    if (!S.next(0, cur)) return;
    Acc acc;
#pragma unroll
    for (int a = 0; a < 2; ++a)
#pragma unroll
        for (int b = 0; b < 2; ++b)
#pragma unroll
            for (int m = 0; m < 4; ++m)
#pragma unroll
                for (int n = 0; n < 2; ++n) acc[a][b][m][n] = (f32x4){0.f, 0.f, 0.f, 0.f};
    bf16x8 At[4][2], B0[2][2], B1[2][2];
    const char* cA = (const char*)(g.A + (long)cur.pm * BM * g.lda + cur.z1 * g.sA1 + cur.z2 * g.sA2);
    const char* cB = (const char*)(g.Bt + (long)cur.pn * BM * g.ldb + cur.z1 * g.sB1 + cur.z2 * g.sB2);
    PG8_STAGE(PG8_SB(0, 0), cB, voffB); PG8_STAGE(PG8_SB(0, 1), cB + hstepB, voffB); PG8_STAGE(PG8_SA(0, 0), cA, voffA); PG8_STAGE(PG8_SA(0, 1), cA + hstepA, voffA);
    if (wr == 1) PG8_BAR;
    PG8_WAIT_V(2); PG8_BAR;
    PG8_STAGE(PG8_SB(1, 0), cB + kstep, voffB); PG8_STAGE(PG8_SA(1, 0), cA + kstep, voffA); PG8_STAGE(PG8_SB(1, 1), cB + hstepB + kstep, voffB);
    PG8_WAIT_V(6); PG8_BAR;
    for (;;) {
        const bool has_next = S.next(ui + 1, nxt);
        const char* nA = has_next ? (const char*)(g.A + (long)nxt.pm * BM * g.lda + nxt.z1 * g.sA1 + nxt.z2 * g.sA2) : cA;
        const char* nB = has_next ? (const char*)(g.Bt + (long)nxt.pn * BM * g.ldb + nxt.z1 * g.sB1 + nxt.z2 * g.sB2) : cB;
        for (int t = 0; t < nt; t += 2) {
            const bool last = (t == nt - 2);
            const char* a1 = cA + (size_t)(t + 1) * kstep;
            const char* a2 = last ? nA : cA + (size_t)(t + 2) * kstep; const char* b2 = last ? nB : cB + (size_t)(t + 2) * kstep;
            const char* a3 = a2 + kstep; const char* b3 = b2 + kstep;
            PG8_LDB(B0, 0, 0); PG8_LDB(B1, 0, 1); PG8_SCHED; PG8_LDA(At, 0, 0); PG8_STAGE(PG8_SA(1, 1), a1 + hstepA, voffA);
            PG8_WAIT_V(8); PG8_WAIT_L(0); PG8_BAR; PG8_MMA(0, 0, At, B0); PG8_MMA(0, 1, At, B1); PG8_BAR; PG8_SCHED;
            PG8_LDA(At, 0, 1); PG8_STAGE(PG8_SB(0, 0), b2, voffB); PG8_STAGE(PG8_SB(0, 1), b2 + hstepB, voffB); PG8_STAGE(PG8_SA(0, 0), a2, voffA);
            PG8_WAIT_V(8); PG8_WAIT_L(0); PG8_BAR; PG8_MMA(1, 0, At, B0); PG8_MMA(1, 1, At, B1); PG8_BAR; PG8_SCHED;
            PG8_LDB(B0, 1, 0); PG8_LDB(B1, 1, 1); PG8_SCHED; PG8_LDA(At, 1, 0); PG8_STAGE(PG8_SA(0, 1), a2 + hstepA, voffA);
            PG8_WAIT_V(8); PG8_WAIT_L(0); PG8_BAR; PG8_MMA(0, 0, At, B0); PG8_MMA(0, 1, At, B1); PG8_BAR; PG8_SCHED;
            PG8_LDA(At, 1, 1); PG8_STAGE(PG8_SB(1, 0), b3, voffB); PG8_STAGE(PG8_SB(1, 1), b3 + hstepB, voffB); PG8_STAGE(PG8_SA(1, 0), a3, voffA);
            PG8_WAIT_V(8); PG8_WAIT_L(0); PG8_BAR; PG8_MMA(1, 0, At, B0); PG8_MMA(1, 1, At, B1); PG8_BAR; PG8_SCHED;
        }
        if constexpr (ALIGN_EPI) { if (wr == 0) PG8_BAR; }
        if constexpr (!Epi::AFTER_DRAIN) { E(acc, cur, wr, wc, fr, fq); }
        if (!has_next) break;
#pragma unroll
        for (int a = 0; a < 2; ++a)
#pragma unroll
            for (int b = 0; b < 2; ++b)
#pragma unroll
                for (int m = 0; m < 4; ++m)
#pragma unroll
                    for (int n = 0; n < 2; ++n) acc[a][b][m][n] = (f32x4){0.f, 0.f, 0.f, 0.f};
        cur = nxt; cA = nA; cB = nB; ++ui;
        if constexpr (ALIGN_EPI) { if (wr == 1) PG8_BAR; }
    }
    PG8_WAIT_V(0);
    if constexpr (!ALIGN_EPI) { if (wr == 0) PG8_BAR; }
    PG8_BAR;
    if constexpr (Epi::AFTER_DRAIN) { E.fused(acc, cur, wr, wc, fr, fq, lds, wid, lane); }
#undef PG8_SA
#undef PG8_SB
#undef PG8_STAGE
#undef PG8_LDA
#undef PG8_LDB
#undef PG8_MMA
#undef PG8_WAIT_V
#undef PG8_WAIT_L
#undef PG8_BAR
#undef PG8_SCHED
}
}

#define XB_TMO      128
#define XB_XCNT(j)  (256  + 64 * (j))
#define XB_XSUB(j)  (1280 + 64 * (j))
#define XB_XGEN(j)  (2304 + 64 * (j))
#define XB_TOP      3328
#define XB_TOPGEN   3392
#define XCD_BAR_WORDS 3456
#define XB_SPIN_CAP (1u << 18)
__device__ __forceinline__ unsigned xb_ld(unsigned* p)              { return __hip_atomic_load(p, __ATOMIC_RELAXED, __HIP_MEMORY_SCOPE_AGENT); }
__device__ __forceinline__ unsigned xb_add(unsigned* p, unsigned v) { return __hip_atomic_fetch_add(p, v, __ATOMIC_RELAXED, __HIP_MEMORY_SCOPE_AGENT); }
__device__ __forceinline__ unsigned xb_xcc_id() { return (unsigned)__builtin_amdgcn_s_getreg((3 << 11) | 20) & 0xFu; }
#define XB_SPIN(cond, bar) do { unsigned _sp = 0; while (cond) { __builtin_amdgcn_s_sleep(1); \
    if ((++_sp & 255u) == 0u) { if (xb_ld(&(bar)[XB_TMO])) break; if (_sp > XB_SPIN_CAP) { atomicAdd(&(bar)[XB_TMO], 1u); break; } } } } while (0)
struct XcdBarrier { unsigned* bar; unsigned x; volatile LAS unsigned* st; };
__device__ __forceinline__ XcdBarrier xcd_barrier_post(unsigned* bar, volatile LAS unsigned* st) {
    XcdBarrier b; b.bar = bar; b.x = xb_xcc_id(); b.st = st;
    if (threadIdx.x == 0) (void)xb_add(&bar[XB_XCNT(b.x)], 1u);
    return b;
}
__device__ __forceinline__ void xcd_barrier_complete(unsigned* bar, unsigned x, unsigned& nloc, unsigned& nx) {
    const unsigned G = gridDim.x * gridDim.y * gridDim.z;
    unsigned sum, cnt, mine, sp = 0u;
    for (;;) {
        sum = 0u; cnt = 0u; mine = 0u;
#pragma unroll
        for (unsigned j = 0; j < 16; ++j) { const unsigned c = xb_ld(&bar[XB_XCNT(j)]); sum += c; cnt += (c > 0u) ? 1u : 0u; mine = (j == x) ? c : mine; }
        if (sum == G) break;
        __builtin_amdgcn_s_sleep(1);
        if ((++sp & 255u) == 0u) { if (xb_ld(&bar[XB_TMO])) break; if (sp > XB_SPIN_CAP) { atomicAdd(&bar[XB_TMO], 1u); break; } }
    }
    nloc = mine > 0u ? mine : 1u; nx = cnt > 0u ? cnt : 1u;
}
__device__ __forceinline__ void xcd_barrier(const XcdBarrier& b) {
    asm volatile("s_waitcnt vmcnt(0)" ::: "memory");
    __syncthreads();
    if (threadIdx.x == 0) {
        unsigned* bar = b.bar;
        __builtin_amdgcn_s_waitcnt(0);
        unsigned nloc = b.st[0], nx = b.st[1];
        if (nloc == 0u) { xcd_barrier_complete(bar, b.x, nloc, nx); b.st[0] = nloc; b.st[1] = nx; }
        const unsigned old = xb_add(&bar[XB_XSUB(b.x)], 1u);
        const unsigned gen = old / nloc;
        if (old + 1u == (gen + 1u) * nloc) {
            __builtin_amdgcn_fence(__ATOMIC_RELEASE, "agent");
            asm volatile("s_waitcnt vmcnt(0)" ::: "memory");
            const unsigned og = xb_add(&bar[XB_TOP], 1u);
            const unsigned tg = og / nx;
            if (og + 1u == (tg + 1u) * nx) xb_add(&bar[XB_TOPGEN], 1u);
            else XB_SPIN(xb_ld(&bar[XB_TOPGEN]) == tg, bar);
            __builtin_amdgcn_fence(__ATOMIC_ACQUIRE, "agent");
            xb_add(&bar[XB_XGEN(b.x)], 1u);
            asm volatile("s_waitcnt vmcnt(0)" ::: "memory");
        } else {
            XB_SPIN(xb_ld(&bar[XB_XGEN(b.x)]) == gen, bar);
            __builtin_amdgcn_fence(__ATOMIC_ACQUIRE, "agent");
            asm volatile("s_waitcnt vmcnt(0)" ::: "memory");
        }
    }
    __syncthreads();
}

__device__ __forceinline__ float wave_sum(float v) {
#pragma unroll
    for (int o = 1; o < 64; o <<= 1) v += __shfl_xor(v, o);
    return v;
}
__device__ __forceinline__ int rowmap(int mode, int n) {
    if (mode == 1) {
        if (n < 2048) { const int l = n & 127, hb = n & ~127, half = l >> 6, i = l & 63; return hb + 8 * (i >> 2) + 4 * half + (i & 3); }
        return n;
    }
    if (mode == 2) {
        if (n < DFF) return 256 * (n >> 7) + (n & 127);
        const int f = n - DFF; return 256 * (f >> 7) + 128 + (f & 127);
    }
    return n;
}
__device__ __forceinline__ void p0_transpose_item(const float* W, int K, int N, bf16_t* WT, int mode, LAS float* scr, int item, int lane) {
    const int nblk = N / 32, kb = item / nblk, nb = item % nblk, k0 = 64 * kb, n0 = 32 * nb;
#pragma unroll 8
    for (int i = 0; i < 32; ++i) { const int kk = 2 * i + (lane >> 5); scr[kk * 33 + (lane & 31)] = W[(size_t)(k0 + kk) * N + n0 + (lane & 31)]; }
    LDS_WAIT(); asm volatile("" ::: "memory");
    const int c = lane & 7;
#pragma unroll
    for (int j = 0; j < 4; ++j) { const int n = (lane >> 3) + 8 * j; const LAS float* s = scr + (8 * c) * 33 + n;
        u32x4 o; o.x = cvt_pk_bf16(s[0 * 33], s[1 * 33]); o.y = cvt_pk_bf16(s[2 * 33], s[3 * 33]); o.z = cvt_pk_bf16(s[4 * 33], s[5 * 33]); o.w = cvt_pk_bf16(s[6 * 33], s[7 * 33]);
        *(u32x4*)(WT + (size_t)rowmap(mode, n0 + n) * K + k0 + 8 * c) = o; }
    LDS_WAIT(); asm volatile("" ::: "memory");
}
__device__ __forceinline__ void cvt_rows(const float* src, bf16_t* dst, size_t n8, int gt, int ngt) {
    for (size_t i = gt; i < n8; i += ngt) { const f32x4 a = *(const f32x4*)(src + i * 8), b = *(const f32x4*)(src + i * 8 + 4);
        u32x4 o; o.x = cvt_pk_bf16(a[0], a[1]); o.y = cvt_pk_bf16(a[2], a[3]); o.z = cvt_pk_bf16(b[0], b[1]); o.w = cvt_pk_bf16(b[2], b[3]);
        *(u32x4*)(dst + i * 8) = o; }
}
__device__ __forceinline__ void sincos_d(double x, float& s, float& c) {
    const double TWO_PI = 6.283185307179586476925286766559, INV_TWO_PI = 0.15915494309189533576888376337251;
    const double k = __builtin_rint(x * INV_TWO_PI);
    double r = __builtin_fma(-k, TWO_PI, x);
    r = __builtin_fma(-k, 2.4492935982947064e-16, r);
    const double q = __builtin_rint(r * 0.63661977236758134308);
    const double y = __builtin_fma(-q, 1.5707963267948966192, r);
    const double y2 = y * y;
    double sp = -1.0 / 1307674368000.0; sp = sp * y2 + 1.0 / 6227020800.0; sp = sp * y2 - 1.0 / 39916800.0; sp = sp * y2 + 1.0 / 362880.0; sp = sp * y2 - 1.0 / 5040.0; sp = sp * y2 + 1.0 / 120.0; sp = sp * y2 - 1.0 / 6.0; sp = sp * y2 + 1.0;
    const double sy = sp * y;
    double cp = 1.0 / 20922789888000.0; cp = cp * y2 - 1.0 / 87178291200.0; cp = cp * y2 + 1.0 / 479001600.0; cp = cp * y2 - 1.0 / 3628800.0; cp = cp * y2 + 1.0 / 40320.0; cp = cp * y2 - 1.0 / 720.0; cp = cp * y2 + 1.0 / 24.0; cp = cp * y2 - 0.5; cp = cp * y2 + 1.0;
    const int qi = ((int)q) & 3;
    const double ss = (qi == 0) ? sy : (qi == 1) ? cp : (qi == 2) ? -sy : -cp;
    const double cc = (qi == 0) ? cp : (qi == 1) ? -sy : (qi == 2) ? -cp : sy;
    s = (float)ss; c = (float)cc;
}
__device__ __forceinline__ float log2_gamma(int h) { return log1pf(-exp2f(-5.0f - (float)h)) * LOG2E; }

__device__ __forceinline__ void swa_unit(LAS unsigned char* lds, int unit, const bf16_t* proj, bf16_t* mix, const float* biasTab, const float* sinks, int tid, int wid, int lane) {
    const int kh = unit & 3, nb = (unit >> 2) & 63, b = unit >> 8;
    const long tok0 = (long)b * SEQ + nb * 128;
    constexpr int KS_OFF = 0, KS_STRIDE = 144, VT_OFF = 256 * 144, VT_STRIDE = 528, PS_OFF = VT_OFF + 64 * 528, PS_WAVE = 16 * 528, BL_OFF = PS_OFF + 8 * PS_WAVE;
    static_assert(BL_OFF + 2048 <= MISC_OFF, "swa LDS");
#pragma unroll
    for (int it = 0; it < 4; ++it) {
        const int c = tid + 512 * it, j = c >> 3, ch = c & 7;
        u32x4 kv = (u32x4){0u, 0u, 0u, 0u}, vv = kv;
        if (nb > 0 || j >= 128) { const bf16_t* src = proj + (size_t)(tok0 - 128 + j) * INW; kv = *(const u32x4*)(src + OFF_KS + kh * 64 + ch * 8); vv = *(const u32x4*)(src + OFF_VS + kh * 64 + ch * 8); }
        *(LAS u32x4*)(lds + KS_OFF + j * KS_STRIDE + ch * 16) = kv;
#pragma unroll
        for (int k = 0; k < 8; ++k) { const unsigned w = vv[k >> 1]; const unsigned short e = (unsigned short)((k & 1) ? (w >> 16) : (w & 0xffffu));
            *(LAS unsigned short*)(lds + VT_OFF + (ch * 8 + k) * VT_STRIDE + j * 2) = e; }
    }
    ((LAS float*)(lds + BL_OFF))[tid] = biasTab[kh * 512 + tid];
    WG_BARRIER();
    const int hl = wid >> 1, hq = kh * 4 + hl, q = lane >> 4, li = lane & 15;
    const float sink2 = sinks[hq] * LOG2E;
    LAS unsigned char* Ps = lds + PS_OFF + wid * PS_WAVE;
    const LAS float* BL = (const LAS float*)(lds + BL_OFF) + hl * 128;
    for (int sl = 0; sl < 4; ++sl) {
        const int i0 = 64 * (wid & 1) + 16 * sl, i = i0 + li;
        const bf16_t* qp = proj + (size_t)(tok0 + i) * INW + OFF_QS + hq * 64 + 8 * q;
        const bf16x8 yq0 = *(const bf16x8*)(qp), yq1 = *(const bf16x8*)(qp + 32);
        const int flo = (i0 + 1) >> 4, fhi = (i0 + 143) >> 4;
        f32x4 s[16];
#pragma unroll
        for (int f = 0; f < 16; ++f) { s[f] = (f32x4){0.f, 0.f, 0.f, 0.f};
            if (f >= flo && f <= fhi) { const LAS unsigned char* kp = lds + KS_OFF + (16 * f + li) * KS_STRIDE + 16 * q;
                const bf16x8 xk0 = *(const LAS bf16x8*)(kp), xk1 = *(const LAS bf16x8*)(kp + 64);
                s[f] = MFMA16(xk0, yq0, s[f]); s[f] = MFMA16(xk1, yq1, s[f]); } }
        float mx = -INFINITY;
#pragma unroll
        for (int f = 0; f < 16; ++f)
#pragma unroll
            for (int r = 0; r < 4; ++r) { const int j = 16 * f + 4 * q + r, dist = i + 128 - j; const bool valid = (dist >= 0) && (dist < 128) && (nb > 0 || j >= 128);
                const float t = valid ? (s[f][r] + BL[dist & 127]) * LOG2E : -INFINITY; s[f][r] = t; mx = fmaxf(mx, t); }
        mx = fmaxf(mx, __shfl_xor(mx, 16)); mx = fmaxf(mx, __shfl_xor(mx, 32));
        const float mm = fmaxf(mx, sink2);
        float sum = 0.f;
#pragma unroll
        for (int f = 0; f < 16; ++f) {
#pragma unroll
            for (int r = 0; r < 4; ++r) { const float p = fast_exp2(s[f][r] - mm); sum += p; s[f][r] = p; }
            u32x2 w; w.x = cvt_pk_bf16(s[f][0], s[f][1]); w.y = cvt_pk_bf16(s[f][2], s[f][3]);
            *(LAS u32x2*)(Ps + li * 528 + (16 * f + 4 * q) * 2) = w; }
        sum += __shfl_xor(sum, 16); sum += __shfl_xor(sum, 32);
        const float inv = 1.0f / (sum + fast_exp2(sink2 - mm));
        const int kslo = (i0 + 1) >> 5, kshi = (i0 + 143) >> 5;
        f32x4 o[4];
#pragma unroll
        for (int ef = 0; ef < 4; ++ef) o[ef] = (f32x4){0.f, 0.f, 0.f, 0.f};
        LDS_WAIT();
#pragma unroll
        for (int ks = 0; ks < 8; ++ks) if (ks >= kslo && ks <= kshi) {
            const bf16x8 yp = *(const LAS bf16x8*)(Ps + li * 528 + (32 * ks + 8 * q) * 2);
#pragma unroll
            for (int ef = 0; ef < 4; ++ef) { const bf16x8 xv = *(const LAS bf16x8*)(lds + VT_OFF + (16 * ef + li) * VT_STRIDE + (32 * ks + 8 * q) * 2); o[ef] = MFMA16(xv, yp, o[ef]); } }
        bf16_t* op = mix + (size_t)(tok0 + i) * DM + 1024 + hq * 64 + 4 * q;
#pragma unroll
        for (int ef = 0; ef < 4; ++ef) { const f32x4 v = o[ef] * inv; u32x2 w; w.x = cvt_pk_bf16(v[0], v[1]); w.y = cvt_pk_bf16(v[2], v[3]); *(u32x2*)(op + 16 * ef) = w; }
        LDS_WAIT();
    }
    WG_BARRIER();
}

__device__ __forceinline__ void retkv_unit(LAS unsigned char* lds, int unit, const bf16_t* proj, float* kvst, int tid, int wid, int lane) {
    const int h = unit & 7, n = (unit >> 3) & 63, b = unit >> 9;
    const long tok0 = (long)b * SEQ + n * 128;
    constexpr int VT_OFF = 0, KT_OFF = 34816, ST = 272;
    const float lg = log2_gamma(h);
#pragma unroll
    for (int it = 0; it < 4; ++it) {
        const int c = tid + 512 * it, j = c >> 4, ch = c & 15;
        const bf16_t* src = proj + (size_t)(tok0 + j) * INW + h * 128 + ch * 8;
        const u32x4 vv = *(const u32x4*)(src + OFF_VR), kk = *(const u32x4*)(src + OFF_KR);
        const float dec = exp2f((float)(127 - j) * lg);
#pragma unroll
        for (int k = 0; k < 8; ++k) { const unsigned wv = vv[k >> 1], wk = kk[k >> 1];
            const float vf = ((k & 1) ? bf_hi(wv) : bf_lo(wv)) * dec;
            const unsigned short ve = (unsigned short)(cvt_pk_bf16(vf, 0.f) & 0xffffu), ke = (unsigned short)((k & 1) ? (wk >> 16) : (wk & 0xffffu));
            *(LAS unsigned short*)(lds + VT_OFF + (ch * 8 + k) * ST + j * 2) = ve;
            *(LAS unsigned short*)(lds + KT_OFF + (ch * 8 + k) * ST + j * 2) = ke; }
    }
    WG_BARRIER();
    const int q = lane >> 4, li = lane & 15;
    bf16x8 xv[4];
#pragma unroll
    for (int ks = 0; ks < 4; ++ks) xv[ks] = *(const LAS bf16x8*)(lds + VT_OFF + (16 * wid + li) * ST + (32 * ks + 8 * q) * 2);
    float* op = kvst + ((size_t)unit * 128 + 16 * wid + 4 * q) * 128 + li;
#pragma unroll
    for (int df = 0; df < 8; ++df) { f32x4 a = (f32x4){0.f, 0.f, 0.f, 0.f};
#pragma unroll
        for (int ks = 0; ks < 4; ++ks) { const bf16x8 yk = *(const LAS bf16x8*)(lds + KT_OFF + (16 * df + li) * ST + (32 * ks + 8 * q) * 2); a = MFMA16(xv[ks], yk, a); }
#pragma unroll
        for (int r = 0; r < 4; ++r) op[(size_t)r * 128 + 16 * df] = a[r]; }
    WG_BARRIER();
}

__device__ __forceinline__ void retout_unit(LAS unsigned char* lds, int unit, const bf16_t* proj, const bf16_t* prev, bf16_t* mix, const float* gn_g, int tid, int wid, int lane) {
    const int h = unit & 7, n = (unit >> 3) & 63, b = unit >> 9;
    const long tok0 = (long)b * SEQ + n * 128;
    constexpr int KS_OFF = 0, VT_OFF = 34816, PT_OFF = 69632, SW_OFF = 104448, ST = 272, SW_WAVE = 16 * 272;
    static_assert(SW_OFF + 8 * SW_WAVE <= MISC_OFF, "retention LDS");
    const float lg = log2_gamma(h);
#pragma unroll
    for (int it = 0; it < 4; ++it) {
        const int c = tid + 512 * it, j = c >> 4, ch = c & 15;
        const bf16_t* src = proj + (size_t)(tok0 + j) * INW + h * 128 + ch * 8;
        const u32x4 vv = *(const u32x4*)(src + OFF_VR), kk = *(const u32x4*)(src + OFF_KR);
        const u32x4 pp = *(const u32x4*)(prev + ((size_t)unit * 128 + j) * 128 + ch * 8);
        *(LAS u32x4*)(lds + KS_OFF + j * ST + ch * 16) = kk;
        *(LAS u32x4*)(lds + PT_OFF + j * ST + ch * 16) = pp;
#pragma unroll
        for (int k = 0; k < 8; ++k) { const unsigned wv = vv[k >> 1]; const unsigned short ve = (unsigned short)((k & 1) ? (wv >> 16) : (wv & 0xffffu));
            *(LAS unsigned short*)(lds + VT_OFF + (ch * 8 + k) * ST + j * 2) = ve; }
    }
    WG_BARRIER();
    const int q = lane >> 4, li = lane & 15, i = 16 * wid + li;
    const bf16_t* qp = proj + (size_t)(tok0 + i) * INW + OFF_QR + h * 128 + 8 * q;
    bf16x8 yq[4];
#pragma unroll
    for (int ks = 0; ks < 4; ++ks) yq[ks] = *(const bf16x8*)(qp + 32 * ks);
    LAS unsigned char* Sw = lds + SW_OFF + wid * SW_WAVE;
#pragma unroll
    for (int jf = 0; jf < 8; ++jf) {
        f32x4 s = (f32x4){0.f, 0.f, 0.f, 0.f};
        if (jf <= wid) {
#pragma unroll
            for (int ks = 0; ks < 4; ++ks) { const bf16x8 xk = *(const LAS bf16x8*)(lds + KS_OFF + (16 * jf + li) * ST + (32 * ks + 8 * q) * 2); s = MFMA16(xk, yq[ks], s); }
#pragma unroll
            for (int r = 0; r < 4; ++r) { const int j = 16 * jf + 4 * q + r; s[r] = (i >= j) ? s[r] * exp2f((float)(i - j) * lg) : 0.f; }
        }
        u32x2 w; w.x = cvt_pk_bf16(s[0], s[1]); w.y = cvt_pk_bf16(s[2], s[3]);
        *(LAS u32x2*)(Sw + li * ST + (16 * jf + 4 * q) * 2) = w;
    }
    LDS_WAIT();
    f32x4 oi[8], oc[8];
#pragma unroll
    for (int ef = 0; ef < 8; ++ef) { oi[ef] = (f32x4){0.f, 0.f, 0.f, 0.f}; oc[ef] = oi[ef]; }
    const int ksmax = wid >> 1;
#pragma unroll
    for (int ks = 0; ks < 4; ++ks) {
        if (ks <= ksmax) { const bf16x8 ys = *(const LAS bf16x8*)(Sw + li * ST + (32 * ks + 8 * q) * 2);
#pragma unroll
            for (int ef = 0; ef < 8; ++ef) { const bf16x8 xv = *(const LAS bf16x8*)(lds + VT_OFF + (16 * ef + li) * ST + (32 * ks + 8 * q) * 2); oi[ef] = MFMA16(xv, ys, oi[ef]); } }
#pragma unroll
        for (int ef = 0; ef < 8; ++ef) { const bf16x8 xp = *(const LAS bf16x8*)(lds + PT_OFF + (16 * ef + li) * ST + (32 * ks + 8 * q) * 2); oc[ef] = MFMA16(xp, yq[ks], oc[ef]); }
    }
    const float qdec = exp2f((float)(i + 1) * lg);
    float sum = 0.f;
#pragma unroll
    for (int ef = 0; ef < 8; ++ef) { oi[ef] = oi[ef] + oc[ef] * qdec; sum += (oi[ef][0] + oi[ef][1]) + (oi[ef][2] + oi[ef][3]); }
    sum += __shfl_xor(sum, 16); sum += __shfl_xor(sum, 32);
    const float mu = sum * (1.0f / 128.0f);
    float var = 0.f;
#pragma unroll
    for (int ef = 0; ef < 8; ++ef) { oi[ef] = oi[ef] - mu; var += (oi[ef][0] * oi[ef][0] + oi[ef][1] * oi[ef][1]) + (oi[ef][2] * oi[ef][2] + oi[ef][3] * oi[ef][3]); }
    var += __shfl_xor(var, 16); var += __shfl_xor(var, 32);
    const float rstd = 1.0f / sqrtf(var * (1.0f / 128.0f) + LN_EPS);
    const bf16_t* gp = proj + (size_t)(tok0 + i) * INW + OFF_GR + h * 128 + 4 * q;
    bf16_t* op = mix + (size_t)(tok0 + i) * DM + h * 128 + 4 * q;
    const float* gg = gn_g + h * 128 + 4 * q;
#pragma unroll
    for (int ef = 0; ef < 8; ++ef) { const u32x2 gw = *(const u32x2*)(gp + 16 * ef); const f32x4 gs = *(const f32x4*)(gg + 16 * ef);
        const float g0 = bf_lo(gw.x), g1 = bf_hi(gw.x), g2 = bf_lo(gw.y), g3 = bf_hi(gw.y);
        const f32x4 v = oi[ef] * rstd * gs;
        u32x2 w; w.x = cvt_pk_bf16(v[0] * silu_f(g0), v[1] * silu_f(g1)); w.y = cvt_pk_bf16(v[2] * silu_f(g2), v[3] * silu_f(g3));
        *(u32x2*)(op + 16 * ef) = w; }
    WG_BARRIER();
}

__device__ __forceinline__ void ln_rows(float* y, const float* g, const float* bta, bf16_t* xb, int gw, int ngw, int lane) {
    for (int m = gw; m < MTOK; m += ngw) {
        f32x4* yr = (f32x4*)(y + (size_t)m * DM) + lane;
        f32x4 v[8]; float s = 0.f;
#pragma unroll
        for (int j = 0; j < 8; ++j) { v[j] = yr[64 * j]; s += (v[j][0] + v[j][1]) + (v[j][2] + v[j][3]); }
        const float mean = wave_sum(s) * (1.0f / DM); float s2 = 0.f;
#pragma unroll
        for (int j = 0; j < 8; ++j) { v[j] = v[j] - mean; s2 += (v[j][0] * v[j][0] + v[j][1] * v[j][1]) + (v[j][2] * v[j][2] + v[j][3] * v[j][3]); }
        const float rstd = 1.0f / sqrtf(wave_sum(s2) * (1.0f / DM) + LN_EPS);
#pragma unroll
        for (int j = 0; j < 8; ++j) { const f32x4 gv = ((const f32x4*)g)[lane + 64 * j], bv = ((const f32x4*)bta)[lane + 64 * j];
            const f32x4 o = v[j] * rstd * gv + bv; yr[64 * j] = o;
            if (xb) { u32x2 w; w.x = cvt_pk_bf16(o[0], o[1]); w.y = cvt_pk_bf16(o[2], o[3]); *((u32x2*)(xb + (size_t)m * DM) + lane + 64 * j) = w; } }
    }
}

constexpr int NPHASE = 17;
struct Args { const float* in[20]; float* out; unsigned char* ws; };

template <int PH> __global__ void __launch_bounds__(NTHR, 2) hybrid_fwd(Args args) {
    extern __shared__ __attribute__((aligned(16))) unsigned char lds_raw[];
    LAS unsigned char* lds = (LAS unsigned char*)lds_raw;
    volatile LAS unsigned* MISC = (volatile LAS unsigned*)(lds + MISC_OFF);
    const int tid = threadIdx.x, lane = tid & 63, wid = __builtin_amdgcn_readfirstlane(tid >> 6);
    const int G = gridDim.x, bx = blockIdx.x;
    const int vcu = (G % 8 == 0) ? (bx % 8) * (G / 8) + bx / 8 : bx;
    const int gw = vcu * NWAVES + wid, ngw = G * NWAVES, gt = vcu * NTHR + tid, ngt = G * NTHR;
    unsigned char* ws = args.ws;
    unsigned* ctl = (unsigned*)(ws + WS_CTL);
    const float* x_in = args.in[0];
    bf16_t* WinT = (bf16_t*)(ws + WS_WIN); bf16_t* WoT = (bf16_t*)(ws + WS_WO); bf16_t* WqT = (bf16_t*)(ws + WS_WQ); bf16_t* WkvT = (bf16_t*)(ws + WS_WKV);
    bf16_t* WxoT = (bf16_t*)(ws + WS_WXO); bf16_t* WupT = (bf16_t*)(ws + WS_WUP); bf16_t* WdnT = (bf16_t*)(ws + WS_WDN);
    bf16_t* XB = (bf16_t*)(ws + WS_XB); bf16_t* MEMB = (bf16_t*)(ws + WS_MEMB); bf16_t* KX = (bf16_t*)(ws + WS_KX); bf16_t* VXT = (bf16_t*)(ws + WS_VXT);
    float* COS = (float*)(ws + WS_ROPE); float* SIN = COS + SEQ * 64; float* BIAS = (float*)(ws + WS_BIAS);
    bf16_t* PROJ = (bf16_t*)(ws + WS_PROJ); float* KVST = (float*)(ws + WS_KVST); bf16_t* PREV = (bf16_t*)(ws + WS_PREV); bf16_t* MIX = (bf16_t*)(ws + WS_MIX);
    bf16_t* XNB = (bf16_t*)(ws + WS_XNB); bf16_t* QX = (bf16_t*)(ws + WS_QX); bf16_t* PBUF = (bf16_t*)(ws + WS_PBUF); bf16_t* OX = (bf16_t*)(ws + WS_OX);
    bf16_t* ACT = (bf16_t*)(ws + WS_ACT); float* TG = (float*)(ws + WS_TG); float* TU = (float*)(ws + WS_TU); float* HG = (float*)(ws + WS_HG);
    float* OUT = args.out;

    for (int u = tid; u < 64; u += NTHR) ((LAS unsigned*)(lds + MISC_OFF))[u] = 0u;
    __syncthreads();
    XcdBarrier bar; bar.bar = ctl + CW_BAR; bar.x = 0; bar.st = nullptr;
    if constexpr (PH < 0) bar = xcd_barrier_post(ctl + CW_BAR, MISC + 8);
#ifdef PH_MASK
#define IN(k) ((((PH_MASK) >> (k)) & 1) && (PH < 0 || PH == (k)))
#else
#define IN(k) (PH < 0 || PH == (k))
#endif
#define SEAM(k) do { if constexpr (PH < 0) xcd_barrier(bar); } while (0)

    if constexpr (IN(0)) {
        LAS float* scr = (LAS float*)(lds + wid * 16384);
        constexpr int I_IN = 32 * (INW / 32), I_O = 32 * 64, I_Q = 32 * 64, I_KV = 32 * 128, I_XO = 32 * 64, I_UP = 32 * (2 * DFF / 32), I_DN = (DFF / 64) * 64;
        constexpr int NITEMS = I_IN + I_O + I_Q + I_KV + I_XO + I_UP + I_DN;
        for (int it = gw; it < NITEMS; it += ngw) {
            int r = it;
            if (r < I_IN) { p0_transpose_item(args.in[2], DM, INW, WinT, 1, scr, r, lane); continue; } r -= I_IN;
            if (r < I_O) { p0_transpose_item(args.in[6], DM, DM, WoT, 0, scr, r, lane); continue; } r -= I_O;
            if (r < I_Q) { p0_transpose_item(args.in[9], DM, DM, WqT, 0, scr, r, lane); continue; } r -= I_Q;
            if (r < I_KV) { p0_transpose_item(args.in[10], DM, 2 * DM, WkvT, 0, scr, r, lane); continue; } r -= I_KV;
            if (r < I_XO) { p0_transpose_item(args.in[11], DM, DM, WxoT, 0, scr, r, lane); continue; } r -= I_XO;
            if (r < I_UP) { p0_transpose_item(args.in[14], DM, 2 * DFF, WupT, 2, scr, r, lane); continue; } r -= I_UP;
            p0_transpose_item(args.in[17], DFF, DM, WdnT, 0, scr, r, lane);
        }
        cvt_rows(x_in, XB, (size_t)MTOK * DM / 8, gt, ngt);
        cvt_rows(args.in[1], MEMB, (size_t)BATCH * MEML * DM / 8, gt, ngt);
        for (int e = gt; e < SEQ * 64; e += ngt) { const int pos = e >> 6, i = e & 63;
            const double inv = exp2(-(double)i * (13.287712379549449 / 64.0));
            float s, c; sincos_d((double)pos * inv, s, c); COS[e] = c; SIN[e] = s; }
        if (gt < 16 * 128) { const int hq = gt >> 7, d = gt & 127; int bk;
            if (d < 16) bk = d; else { const float nf = (float)d; int lg_ = 16 + (int)(logf(nf / 16.0f) / 2.0794415416798357f * 16.0f); bk = lg_ < 31 ? lg_ : 31; }
            BIAS[gt] = args.in[5][bk * 16 + hq]; }
    }
    SEAM(0);
    if constexpr (IN(1)) {
        { pg8::Gemm g{XB, WinT, DM, DM, DM, 0, 0, 0, 0}; pg8::StaticOrder S; S.init(MTOK, INW, G, bx);
          pg8::EpiProj E{PROJ, COS, SIN};
          pg8::gemm_phase<pg8::EpiProj, pg8::StaticOrder, true>(lds, g, S, E); }
        { pg8::Gemm g{MEMB, WkvT, DM, DM, DM, 0, 0, 0, 0}; pg8::StaticOrder S; S.init(BATCH * MEML, DM, G, (bx >= 128 && bx < 144) ? bx - 128 : -1);
          pg8::EpiBf16G E{KX, DM, 1.0f, 0, 0};
          pg8::gemm_phase<pg8::EpiBf16G, pg8::StaticOrder, true>(lds, g, S, E); }
        { pg8::Gemm g{WkvT + (size_t)DM * DM, MEMB, DM, DM, DM, 0, 0, 0, 0}; pg8::StaticOrder S; S.init(DM, BATCH * MEML, G, (bx >= 144 && bx < 160) ? bx - 144 : -1);
          pg8::EpiBf16G E{VXT, BATCH * MEML, 1.0f, 0, 0};
          pg8::gemm_phase<pg8::EpiBf16G, pg8::StaticOrder, true>(lds, g, S, E); }
    }
    SEAM(1);
    if constexpr (IN(2)) {
        for (int u = vcu; u < 512; u += G) swa_unit(lds, u, PROJ, MIX, BIAS, args.in[4], tid, wid, lane);
        for (int u = vcu; u < 1024; u += G) retkv_unit(lds, u, PROJ, KVST, tid, wid, lane);
    }
    SEAM(2);
    if constexpr (IN(3)) {
        const int bh = gt >> 13, el = (gt & 8191) * 2;
        if (bh < 16) {
            const int b = bh >> 3, h = bh & 7; const float cd = exp2f(128.0f * log2_gamma(h));
            float s0 = 0.f, s1 = 0.f;
#pragma unroll 8
            for (int n = 0; n < 64; ++n) { const size_t idx = ((size_t)((b * 64 + n) * 8 + h) << 14) + el;
                const f32x2 kv = *(const f32x2*)(KVST + idx);
                *(unsigned*)(PREV + idx) = cvt_pk_bf16(s0, s1);
                s0 = s0 * cd + kv.x; s1 = s1 * cd + kv.y; }
        }
    }
    SEAM(3);
    if constexpr (IN(4)) {
        for (int u = vcu; u < 1024; u += G) retout_unit(lds, u, PROJ, PREV, MIX, args.in[3], tid, wid, lane);
    }
    SEAM(4);
    if constexpr (IN(5)) {
        pg8::Gemm g{MIX, WoT, DM, DM, DM, 0, 0, 0, 0}; pg8::StaticOrder S; S.init(MTOK, DM, G, bx);
        pg8::EpiResF32 E{x_in, OUT, DN_ALPHA};
        pg8::gemm_phase<pg8::EpiResF32, pg8::StaticOrder, true>(lds, g, S, E);
    }
    SEAM(5);
    if constexpr (IN(6)) ln_rows(OUT, args.in[7], args.in[8], XNB, gw, ngw, lane);
    SEAM(6);
    if constexpr (IN(7)) {
        pg8::Gemm g{XNB, WqT, DM, DM, DM, 0, 0, 0, 0}; pg8::StaticOrder S; S.init(MTOK, DM, G, bx);
        pg8::EpiBf16G E{QX, DM, 0.044194173824159216f * LOG2E, 0, 0};
        pg8::gemm_phase<pg8::EpiBf16G, pg8::StaticOrder, true>(lds, g, S, E);
    }
    SEAM(7);
    if constexpr (IN(8)) {
        pg8::Gemm g{QX, KX, DM, DM, 512, (long)SEQ * DM, 512, (long)MEML * DM, 512}; pg8::OrderQK S{G, bx};
        pg8::EpiSoftmax E{PBUF};
        pg8::gemm_phase<pg8::EpiSoftmax, pg8::OrderQK, false>(lds, g, S, E);
    }
    SEAM(8);
    if constexpr (IN(9)) {
        pg8::Gemm g{PBUF, VXT, 256, BATCH * MEML, 256, (long)SEQ * 256, (long)MTOK * 256, 256, (long)512 * (BATCH * MEML)}; pg8::OrderPV S{G, bx};
        pg8::EpiBf16G E{OX, DM, 1.0f, (long)SEQ * DM, 512};
        pg8::gemm_phase<pg8::EpiBf16G, pg8::OrderPV, true>(lds, g, S, E);
    }
    SEAM(9);
    if constexpr (IN(10)) {
        pg8::Gemm g{OX, WxoT, DM, DM, DM, 0, 0, 0, 0}; pg8::StaticOrder S; S.init(MTOK, DM, G, bx);
        pg8::EpiResF32 E{OUT, OUT, DN_ALPHA};
        pg8::gemm_phase<pg8::EpiResF32, pg8::StaticOrder, true>(lds, g, S, E);
    }
    SEAM(10);
    if constexpr (IN(11)) ln_rows(OUT, args.in[12], args.in[13], XNB, gw, ngw, lane);
    SEAM(11);
    if constexpr (IN(12)) {
        pg8::Gemm g{XNB, WupT, DM, DM, DM, 0, 0, 0, 0}; pg8::StaticOrder S; S.init(MTOK, 2 * DFF, G, bx);
        pg8::EpiUpGate E{ACT, TG, TU, HG, args.in[15], args.in[16]};
        pg8::gemm_phase<pg8::EpiUpGate, pg8::StaticOrder, true>(lds, g, S, E);
    }
    SEAM(12);
    if constexpr (IN(13)) {
        const float* cw = args.in[15]; const float* cb = args.in[16];
        constexpr int NIT = 256 * 2 * (DFF / 4);
        for (int it = gt; it < NIT; it += ngt) {
            const int f = (it % (DFF / 4)) * 4, rr = (it / (DFF / 4)) & 1, Gi = it / (2 * (DFF / 4));
            const bool bstart = (Gi & 127) == 0;
            const f32x4 z = (f32x4){0.f, 0.f, 0.f, 0.f};
            const f32x4 g0 = *(const f32x4*)(TG + (size_t)(Gi * 2 + rr) * DFF + f);
            const f32x4 hm1 = bstart ? z : *(const f32x4*)(HG + (size_t)((Gi - 1) * 2 + 1) * DFF + f);
            const f32x4 hm2 = bstart ? z : *(const f32x4*)(HG + (size_t)((Gi - 1) * 2 + 0) * DFF + f);
            const f32x4 g1 = rr ? *(const f32x4*)(TG + (size_t)(Gi * 2) * DFF + f) : hm1;
            const f32x4 g2 = rr ? hm1 : hm2;
            const f32x4 uu = *(const f32x4*)(TU + (size_t)(Gi * 2 + rr) * DFF + f);
            const f32x4 gc = *(const f32x4*)(cb + f) + *(const f32x4*)(cw + f) * g2 + *(const f32x4*)(cw + DFF + f) * g1 + *(const f32x4*)(cw + 2 * DFF + f) * g0;
            u32x2 w; w.x = cvt_pk_bf16(silu_f(gc[0]) * uu[0], silu_f(gc[1]) * uu[1]); w.y = cvt_pk_bf16(silu_f(gc[2]) * uu[2], silu_f(gc[3]) * uu[3]);
            *(u32x2*)(ACT + (size_t)(Gi * 64 + rr) * DFF + f) = w;
        }
    }
    SEAM(13);
    if constexpr (IN(14)) {
        pg8::Gemm g{ACT, WdnT, DFF, DFF, DFF, 0, 0, 0, 0}; pg8::StaticOrder S; S.init(MTOK, DM, G, bx);
        pg8::EpiResF32 E{OUT, OUT, DN_ALPHA};
        pg8::gemm_phase<pg8::EpiResF32, pg8::StaticOrder, true>(lds, g, S, E);
    }
    SEAM(14);
    if constexpr (IN(15)) ln_rows(OUT, args.in[18], args.in[19], nullptr, gw, ngw, lane);
#undef IN
#undef SEAM
}

#include <utility>
template <int PH> static bool set_attr() { return hipFuncSetAttribute((const void*)hybrid_fwd<PH>, hipFuncAttributeMaxDynamicSharedMemorySize, LDS_BYTES) == hipSuccess; }
template <int... P> static bool set_attr_all(std::integer_sequence<int, P...>) { bool ok = true; ((ok = ok && set_attr<P>()), ...); return ok; }
template <int PH> static int launch_one(int grid, hipStream_t stream, const Args& a) { hybrid_fwd<PH><<<dim3(grid), dim3(NTHR), LDS_BYTES, stream>>>(a); return 0; }
template <int... P> static void launch_all(std::integer_sequence<int, P...>, int grid, hipStream_t stream, const Args& a) { int d[] = {launch_one<P>(grid, stream, a)...}; (void)d; }
extern "C" void kernel_launch(void* const* d_in, const int* in_sizes, int n_in, void* d_out, int out_size, void* d_ws, size_t ws_size, hipStream_t stream) {
    static int grid = 0;
    if (grid == 0) {
        if (n_in != 20 || in_sizes[0] != MTOK * DM || out_size != MTOK * DM || ws_size < WS_END) {
            fprintf(stderr, "kernel_launch: unexpected problem: n_in %d in0 %d out %d ws %zu (need >= %zu); nothing launched\n", n_in, n_in > 0 ? in_sizes[0] : -1, out_size, ws_size, (size_t)WS_END); grid = -1; return; }
        int dev = 0, cus = 0;
        if (hipGetDevice(&dev) != hipSuccess || hipDeviceGetAttribute(&cus, hipDeviceAttributeMultiprocessorCount, dev) != hipSuccess) { grid = -1; return; }
        bool okattr = true;
#if MK_ONE_LAUNCH
        okattr = set_attr<-1>();
        int per_cu = 0;
        if (hipOccupancyMaxActiveBlocksPerMultiprocessor(&per_cu, (const void*)hybrid_fwd<-1>, NTHR, LDS_BYTES) != hipSuccess || per_cu < 1) fprintf(stderr, "kernel_launch: occupancy query reports %d blocks/CU\n", per_cu);
        (void)hipGetLastError();
#else
        okattr = set_attr_all(std::make_integer_sequence<int, NPHASE - 1>{});
#endif
        if (!okattr) { fprintf(stderr, "kernel_launch: hipFuncSetAttribute failed\n"); grid = -1; return; }
        grid = cus;
        if (grid != 256) fprintf(stderr, "kernel_launch: %d CUs (built for 256)\n", grid);
    }
    if (grid < 0) return;
    (void)hipMemsetAsync((char*)d_ws + WS_CTL, 0, CTL_ZERO_BYTES, stream);
    Args a{};
    for (int i = 0; i < 20; ++i) a.in[i] = (const float*)d_in[i];
    a.out = (float*)d_out; a.ws = (unsigned char*)d_ws;
#if MK_ONE_LAUNCH
    (void)launch_one<-1>(grid, stream, a);
#else
    launch_all(std::make_integer_sequence<int, NPHASE - 1>{}, grid, stream, a);
#endif
}
```
